# Optimizing an MI355X kernel written in HIP

```python
import math
import jax, jax.numpy as jnp
from jax import lax
import numpy as np

D_MODEL = 1024
BATCH = 8
SEQ = 8192
DEPTH = 1

PLE_DIM = 256
ATTN_HEADS = 8
HEAD_DIM = 64
ATTN_WIDTH = ATTN_HEADS * HEAD_DIM
MOBA_BLOCK = 256
MOBA_TOPK = 3
Q_CHUNK = 128
REL_BUCKETS = 32
REL_MAX_DIST = 128
SSM_WIDTH = 512
SSM_GROUP = 16
SSM_GROUPS = SSM_WIDTH // SSM_GROUP
SSM_STATE = 64
DT_MIN = 1e-3
DT_MAX = 1e-1
IN_SIZES = (ATTN_WIDTH, ATTN_WIDTH, ATTN_WIDTH, ATTN_WIDTH,
            SSM_WIDTH, SSM_WIDTH,
            D_MODEL, D_MODEL)
IN_WIDTH = sum(IN_SIZES)
IN_SPLITS = tuple(int(s) for s in np.cumsum(IN_SIZES)[:-1])
DEEPNORM_ALPHA = (2.0 * DEPTH) ** 0.25
DEEPNORM_BETA = (8.0 * DEPTH) ** -0.25
LN_EPS = 1e-5

kernel_name = "moba_s5_gated_hybrid_deepnorm"


def t5_bucket(dist):
    max_exact = REL_BUCKETS // 2
    is_small = dist < max_exact
    d = jnp.maximum(dist, 1).astype(jnp.float32)
    large = max_exact + (jnp.log(d / max_exact) / math.log(REL_MAX_DIST / max_exact)
                         * (REL_BUCKETS - max_exact)).astype(jnp.int32)
    large = jnp.minimum(large, REL_BUCKETS - 1)
    return jnp.where(is_small, dist, large)


def moba_attention(q, k, v, rel_bias):
    B, H, S, Dh = q.shape
    f32 = jnp.float32
    nb = -(-S // MOBA_BLOCK)
    s_pad = nb * MOBA_BLOCK
    pad = ((0, 0), (0, 0), (0, s_pad - S), (0, 0))
    q = jnp.pad(q, pad)
    k = jnp.pad(k, pad)
    v = jnp.pad(v, pad)
    kb = k.reshape(B, H, nb, MOBA_BLOCK, Dh)
    vb = v.reshape(B, H, nb, MOBA_BLOCK, Dh)
    k_mean = kb.astype(f32).mean(axis=3)
    topk = min(MOBA_TOPK, nb)
    n_chunks = s_pad // Q_CHUNK
    q_chunks = q.reshape(B, H, n_chunks, Q_CHUNK, Dh).transpose(2, 0, 1, 3, 4)
    bias_table = rel_bias.T
    scale = Dh ** -0.5
    offs = jnp.arange(MOBA_BLOCK)
    b_ix = jnp.arange(B)[:, None, None, None]
    h_ix = jnp.arange(H)[None, :, None, None]
    h_ix5 = jnp.arange(H)[None, :, None, None, None]

    def chunk_fn(args):
        qc, ci = args
        q_pos = ci * Q_CHUNK + jnp.arange(Q_CHUNK)
        blk = (ci * Q_CHUNK) // MOBA_BLOCK
        gate = jnp.einsum('bhqd,bhnd->bhqn', qc.astype(f32), k_mean)
        past = jnp.arange(nb) < blk
        gate = jnp.where(past, gate, -jnp.inf)
        _, idx = lax.top_k(gate, topk)
        valid = idx < blk
        k_sel = kb[b_ix, h_ix, idx]
        v_sel = vb[b_ix, h_ix, idx]
        k_pos = idx[..., None] * MOBA_BLOCK + offs
        logit_sel = jnp.einsum('bhqd,bhqnkd->bhqnk', qc, k_sel).astype(f32) * scale
        dist_sel = jnp.maximum(q_pos[None, None, :, None, None] - k_pos, 0)
        bias_sel = bias_table[h_ix5, t5_bucket(dist_sel)].astype(f32)
        logit_sel = jnp.where(valid[..., None], logit_sel + bias_sel, -jnp.inf)
        k_own = lax.dynamic_index_in_dim(kb, blk, axis=2, keepdims=False)
        v_own = lax.dynamic_index_in_dim(vb, blk, axis=2, keepdims=False)
        own_pos = blk * MOBA_BLOCK + offs
        dist_own = q_pos[:, None] - own_pos[None, :]
        logit_own = jnp.einsum('bhqd,bhkd->bhqk', qc, k_own).astype(f32) * scale
        bias_own = bias_table[:, t5_bucket(jnp.maximum(dist_own, 0))].astype(f32)
        logit_own = jnp.where(dist_own >= 0, logit_own + bias_own, -jnp.inf)
        logits = jnp.concatenate(
            [logit_sel.reshape(B, H, Q_CHUNK, topk * MOBA_BLOCK), logit_own], axis=-1)
        probs = jax.nn.softmax(logits, axis=-1)
        p_sel = probs[..., :topk * MOBA_BLOCK].reshape(B, H, Q_CHUNK, topk, MOBA_BLOCK)
        p_own = probs[..., topk * MOBA_BLOCK:]
        out = (jnp.einsum('bhqnk,bhqnkd->bhqd', p_sel, v_sel.astype(f32))
               + jnp.einsum('bhqk,bhkd->bhqd', p_own, v_own.astype(f32)))
        return out.astype(q.dtype)

    out = lax.map(chunk_fn, (q_chunks, jnp.arange(n_chunks)))
    out = out.transpose(1, 0, 3, 2, 4).reshape(B, s_pad, H * Dh)
    return out[:, :S]


def s5_ssm(u, a_re, a_im, log_dt, b_re, b_im, c_re, c_im, d_skip):
    B, S, W = u.shape
    f32 = jnp.float32
    ug = u.reshape(B, S, SSM_GROUPS, SSM_GROUP).astype(f32)
    ar = a_re.astype(f32)
    ai = a_im.astype(f32)
    dt = jnp.exp(log_dt.astype(f32))[:, None]
    mag = jnp.exp(dt * ar)
    ang = dt * ai
    abar_re = mag * jnp.cos(ang)
    abar_im = mag * jnp.sin(ang)
    den = ar * ar + ai * ai
    nr = abar_re - 1.0
    ni = abar_im
    fr = (nr * ar + ni * ai) / den
    fi = (ni * ar - nr * ai) / den
    br = b_re.astype(f32)
    bi = b_im.astype(f32)
    bbar_re = fr[..., None] * br - fi[..., None] * bi
    bbar_im = fr[..., None] * bi + fi[..., None] * br
    bu_re = jnp.einsum('bsgc,gpc->bsgp', ug, bbar_re)
    bu_im = jnp.einsum('bsgc,gpc->bsgp', ug, bbar_im)
    a_re_t = jnp.broadcast_to(abar_re, bu_re.shape)
    a_im_t = jnp.broadcast_to(abar_im, bu_re.shape)

    def combine(lhs, rhs):
        a1r, a1i, b1r, b1i = lhs
        a2r, a2i, b2r, b2i = rhs
        return (a2r * a1r - a2i * a1i,
                a2r * a1i + a2i * a1r,
                a2r * b1r - a2i * b1i + b2r,
                a2r * b1i + a2i * b1r + b2i)

    _, _, h_re, h_im = lax.associative_scan(combine, (a_re_t, a_im_t, bu_re, bu_im), axis=1)
    y = (jnp.einsum('bsgp,gcp->bsgc', h_re, c_re.astype(f32))
         - jnp.einsum('bsgp,gcp->bsgc', h_im, c_im.astype(f32)))
    y = y.reshape(B, S, W) + d_skip.astype(f32) * u.astype(f32)
    return y.astype(u.dtype)


def layer_norm(x, g, b):
    xf = x.astype(jnp.float32)
    mu = jnp.mean(xf, axis=-1, keepdims=True)
    var = jnp.mean(jnp.square(xf - mu), axis=-1, keepdims=True)
    y = (xf - mu) * lax.rsqrt(var + LN_EPS) * g.astype(jnp.float32) + b.astype(jnp.float32)
    return y.astype(x.dtype)


def setup_inputs(seed: int = 0) -> dict:
    key = jax.random.key(seed)
    ks = jax.random.split(key, 20)
    f32 = jnp.float32

    def nrm(k, shape, scale):
        return scale * jax.random.normal(k, shape, f32)

    n = jnp.arange(SSM_STATE, dtype=f32)
    return {
        'x': nrm(ks[0], (BATCH, SEQ, D_MODEL), 1.0),
        'p': nrm(ks[1], (DEPTH, BATCH, SEQ, PLE_DIM), 1.0),
        'w_in': nrm(ks[2], (DEPTH, D_MODEL, IN_WIDTH), D_MODEL ** -0.5),
        'w_attn_proj': nrm(ks[3], (DEPTH, ATTN_WIDTH, D_MODEL), ATTN_WIDTH ** -0.5),
        'w_ssm_proj': nrm(ks[4], (DEPTH, SSM_WIDTH, D_MODEL), SSM_WIDTH ** -0.5),
        'w_out': nrm(ks[5], (DEPTH, D_MODEL, D_MODEL), DEEPNORM_BETA * D_MODEL ** -0.5),
        'ssm_a_re': -0.5 * jnp.exp(nrm(ks[6], (DEPTH, SSM_GROUPS, SSM_STATE), 0.05)),
        'ssm_a_im': math.pi * n + nrm(ks[7], (DEPTH, SSM_GROUPS, SSM_STATE), 0.01),
        'ssm_log_dt': jax.random.uniform(ks[8], (DEPTH, SSM_GROUPS), f32,
                                         math.log(DT_MIN), math.log(DT_MAX)),
        'ssm_b_re': nrm(ks[9], (DEPTH, SSM_GROUPS, SSM_STATE, SSM_GROUP), (2 * SSM_GROUP) ** -0.5),
        'ssm_b_im': nrm(ks[10], (DEPTH, SSM_GROUPS, SSM_STATE, SSM_GROUP), (2 * SSM_GROUP) ** -0.5),
        'ssm_c_re': nrm(ks[11], (DEPTH, SSM_GROUPS, SSM_GROUP, SSM_STATE), SSM_STATE ** -0.5),
        'ssm_c_im': nrm(ks[12], (DEPTH, SSM_GROUPS, SSM_GROUP, SSM_STATE), SSM_STATE ** -0.5),
        'ssm_d': nrm(ks[13], (DEPTH, SSM_WIDTH), 1.0),
        'w_glu': nrm(ks[14], (DEPTH, SSM_WIDTH, 2 * SSM_WIDTH), SSM_WIDTH ** -0.5),
        'w_ple_gate': nrm(ks[15], (DEPTH, D_MODEL, D_MODEL), D_MODEL ** -0.5),
        'w_ple_proj': nrm(ks[16], (DEPTH, PLE_DIM, D_MODEL), PLE_DIM ** -0.5),
        'ln_g': 1.0 + nrm(ks[17], (DEPTH, D_MODEL), 0.02),
        'ln_b': nrm(ks[18], (DEPTH, D_MODEL), 0.02),
        'rel_bias': nrm(ks[19], (REL_BUCKETS, ATTN_HEADS), 0.5),
    }


def reference(x, p, w_in, w_attn_proj, w_ssm_proj, w_out, ssm_a_re, ssm_a_im, ssm_log_dt,
              ssm_b_re, ssm_b_im, ssm_c_re, ssm_c_im, ssm_d, w_glu, w_ple_gate, w_ple_proj,
              ln_g, ln_b, rel_bias):
    B, S, _ = x.shape

    def heads(t):
        return t.reshape(B, S, ATTN_HEADS, HEAD_DIM).transpose(0, 2, 1, 3)

    for i in range(DEPTH):
        proj = x @ w_in[i]
        q, k, v, z_a, u, z_s, g_a, g_s = jnp.split(proj, IN_SPLITS, axis=-1)
        o_a = moba_attention(heads(q), heads(k), heads(v), rel_bias)
        y_a = (o_a * jax.nn.silu(z_a)) @ w_attn_proj[i]
        y_s = s5_ssm(u, ssm_a_re[i], ssm_a_im[i], ssm_log_dt[i], ssm_b_re[i], ssm_b_im[i],
                     ssm_c_re[i], ssm_c_im[i], ssm_d[i])
        glu_a, glu_b = jnp.split(jax.nn.gelu(y_s, approximate=False) @ w_glu[i], 2, axis=-1)
        y_s = glu_a * jax.nn.sigmoid(glu_b)
        y_s = (y_s * jax.nn.silu(z_s)) @ w_ssm_proj[i]
        mix = (jax.nn.sigmoid(g_a) * y_a + jax.nn.sigmoid(g_s) * y_s) @ w_out[i]
        ple = jax.nn.sigmoid(x @ w_ple_gate[i]) * (p[i] @ w_ple_proj[i])
        x = layer_norm(DEEPNORM_ALPHA * x + mix + ple, ln_g[i], ln_b[i])
    return x
```

```cpp
#include <hip/hip_runtime.h>
#include <hip/hip_cooperative_groups.h>
#include <cstdio>
#include <cstdint>
namespace cg = cooperative_groups;

#define LAS __attribute__((address_space(3)))
typedef unsigned short bf16_t;
typedef short bf16x8 __attribute__((ext_vector_type(8)));
typedef float f32x4 __attribute__((ext_vector_type(4)));
typedef float f32x2 __attribute__((ext_vector_type(2)));
typedef float f32x16 __attribute__((ext_vector_type(16)));
typedef unsigned u32x4 __attribute__((ext_vector_type(4)));
typedef unsigned u32x2 __attribute__((ext_vector_type(2)));
typedef __bf16 bf16x2_t __attribute__((ext_vector_type(2)));

constexpr int NWAVES = 8, NTHR = 512;
constexpr int BATCH = 8, SEQ = 8192, DM = 1024, T = BATCH * SEQ;
constexpr int NPANEL = T / 256;
constexpr int NH = 8, HD = 64, AW = 512, PLE = 256;
constexpr int SG = 32, SP = 64, SC = 16;
constexpr float LN_EPS = 1e-5f;
constexpr float ALPHA = 1.189207115002721f;
constexpr float LOG2E = 1.4426950408889634f;
constexpr float QSCALE = 0.125f * LOG2E;
constexpr int LDS_BYTES = 147456;

constexpr size_t MiB = 1u << 20;
constexpr size_t WS_CONST = 1 * MiB;
constexpr size_t C_ABAR = 0, C_A256 = 16384, C_BBAR = 32768, C_CFRAG = 294912, C_LUT = 425984, C_KNH = 434176, C_KMEAN = 524288;
constexpr size_t WS_WIN = 4 * MiB, WS_WAP = 14 * MiB, WS_WSP = 15 * MiB, WS_WOUT = 16 * MiB, WS_WGLU = 18 * MiB, WS_WPG = 19 * MiB, WS_WPP = 21 * MiB;
constexpr size_t WS_HLOC = 24 * MiB;
constexpr size_t WS_XB = 32 * MiB, WS_PB = 160 * MiB;
constexpr size_t WS_QB = 192 * MiB, WS_BUFSTRIDE = 64 * MiB;
constexpr size_t WS_VT = 512 * MiB, WS_GY = 576 * MiB, WS_OZS = 640 * MiB, WS_MERGE = 704 * MiB, WS_SCR = 832 * MiB, WS_END = 960 * MiB;

__device__ __forceinline__ unsigned cvtpk(float lo, float hi) { f32x2 v = {lo, hi}; bf16x2_t b = __builtin_convertvector(v, bf16x2_t); return __builtin_bit_cast(unsigned, b); }
__device__ __forceinline__ float bf2f(unsigned short h) { return __uint_as_float(((unsigned)h) << 16); }
__device__ __forceinline__ float bflo(unsigned w) { return __uint_as_float(w << 16); }
__device__ __forceinline__ float bfhi(unsigned w) { return __uint_as_float(w & 0xffff0000u); }
__device__ __forceinline__ float sigmoidf_(float x) { return __builtin_amdgcn_rcpf(1.0f + __builtin_amdgcn_exp2f(-x * LOG2E)); }
__device__ __forceinline__ f32x4 sig4(f32x4 v) { f32x4 r; r.x = sigmoidf_(v.x); r.y = sigmoidf_(v.y); r.z = sigmoidf_(v.z); r.w = sigmoidf_(v.w); return r; }
__device__ __forceinline__ float siluf_(float x) { return x * sigmoidf_(x); }
__device__ __forceinline__ int crow(int r, int hi) { return (r & 3) + 8 * (r >> 2) + 4 * hi; }
__device__ __forceinline__ float gelu_f(float v) {
    const float av = __builtin_fabsf(v), t = __builtin_amdgcn_rcpf(av * 0.2316418882f + 1.0f);
    float q = t * 0.5307027145f + (-0.7265760135f); q = q * t + 0.7107068705f; q = q * t + (-0.142248368f); q = q * t + 0.127414796f; q = q * t;
    const float e = __builtin_amdgcn_exp2f((v * v) * (-0.72134752044f));
    const float m = v * (q * e);
    return v < 0.f ? m : v - m;
}

namespace pg8 {
constexpr int BM = 256, BK = 64, HALF = 128, HTB = HALF * BK * 2, STAGE_BYTES = 8 * HTB;
__device__ __forceinline__ int lds_byte(int r, int c) { const int st = (r >> 4) * 2 + (c >> 5), rr = r & 15, cc = c & 31, ob = rr * 64 + cc * 2; return st * 1024 + (ob ^ (((ob >> 9) & 1) << 5)); }
__device__ __forceinline__ void stage_rc(int b, int& R, int& C) { const int st = b / 1024, sb = b % 1024, swz = sb ^ (((sb >> 9) & 1) << 5); R = (st >> 1) * 16 + swz / 64; C = (st & 1) * 32 + (swz % 64) / 2; }
__device__ __forceinline__ int perm32(int rho) { const int n = rho >> 4, i = rho & 15; return 8 * (i >> 2) + 4 * n + (i & 3); }

struct GUnit { const bf16_t* A; const bf16_t* B; int K; int kind; int pm; int pn; int dep; int pad; };

template <class Sched, class Epi>
__device__ __forceinline__ void gemm_units(LAS unsigned char* lds, const Sched& S, const Epi& E) {
    const int tid = threadIdx.x, wid = __builtin_amdgcn_readfirstlane(tid >> 6), lane = tid & 63, wr = wid >> 2, wc = wid & 3, fr = lane & 15, fq = lane >> 4;
    unsigned vbA[2], vbB[2];
#pragma unroll
    for (int i = 0; i < 2; ++i) { int R_, C_; stage_rc(tid * 16 + i * 8192, R_, C_); const int Rb_ = (R_ & ~31) + perm32(R_ & 31);
        vbA[i] = (unsigned)(R_ * 1024 + C_) * 2u; vbB[i] = (unsigned)(Rb_ * 1024 + C_) * 2u; }
    asm volatile("" : "+v"(vbA[0]), "+v"(vbA[1]), "+v"(vbB[0]), "+v"(vbB[1]));
    const size_t kstep = (size_t)(BK * 2);
    const unsigned ldsw = (unsigned)wid * 1024u;
    const int aoff = lds_byte(wr * 64 + fr, fq * 8), boff = lds_byte(wc * 32 + fr, fq * 8);
#define PG8_SA(b, h) (((b) * 2 + (h)) * HTB)
#define PG8_SB(b, h) ((4 + (b) * 2 + (h)) * HTB)
#define PG8_VOFF(b, K2) ((((b) >> 11) * (unsigned)(K2)) + ((b) & 2047u))
#define PG8_STAGE(bufoff, gbase, vb, K2) do { _Pragma("unroll") for (int _i = 0; _i < 2; ++_i) \
        __builtin_amdgcn_global_load_lds((const unsigned*)((const char*)(gbase) + PG8_VOFF((vb)[_i], K2)), (LAS unsigned*)(lds + (bufoff) + ldsw + _i * 8192), 16, 0, 0); } while (0)
#define PG8_LDA(dst, b, h) do { _Pragma("unroll") for (int m = 0; m < 4; ++m) _Pragma("unroll") for (int k = 0; k < 2; ++k) dst[m][k] = *(const LAS bf16x8*)(lds + PG8_SA(b, h) + aoff + m * 2048 + k * 1024); } while (0)
#define PG8_LDB(dst, b, h) do { _Pragma("unroll") for (int n = 0; n < 2; ++n) _Pragma("unroll") for (int k = 0; k < 2; ++k) dst[n][k] = *(const LAS bf16x8*)(lds + PG8_SB(b, h) + boff + n * 2048 + k * 1024); } while (0)
#define PG8_MMA(ai, bj, At, Bt) do { __builtin_amdgcn_s_setprio(1); _Pragma("unroll") for (int m = 0; m < 4; ++m) _Pragma("unroll") for (int n = 0; n < 2; ++n) _Pragma("unroll") for (int k = 0; k < 2; ++k) \
        acc[ai][bj][m][n] = __builtin_amdgcn_mfma_f32_16x16x32_bf16(Bt[n][k], At[m][k], acc[ai][bj][m][n], 0, 0, 0); __builtin_amdgcn_s_setprio(0); } while (0)
#define PG8_WAIT_V(n) asm volatile("s_waitcnt vmcnt(" #n ")" ::: "memory")
#define PG8_WAIT_L(n) asm volatile("s_waitcnt lgkmcnt(" #n ")" ::: "memory")
#define PG8_BAR __builtin_amdgcn_s_barrier()
#define PG8_SCHED __builtin_amdgcn_sched_barrier(0)
    GUnit cur, nxt; int ui = 0;
    if (!S.next(0, cur)) return;
    f32x4 acc[2][2][4][2];
#pragma unroll
    for (int a = 0; a < 2; ++a)
#pragma unroll
        for (int b = 0; b < 2; ++b)
#pragma unroll
            for (int m = 0; m < 4; ++m)
#pragma unroll
                for (int n = 0; n < 2; ++n) acc[a][b][m][n] = (f32x4){0.f, 0.f, 0.f, 0.f};
    bf16x8 At[4][2], B0[2][2], B1[2][2];
    const char* cA = (const char*)cur.A; const char* cB = (const char*)cur.B;
    int kc = cur.K * 2, kn;
    size_t hc = (size_t)HALF * kc, hn;
    S.a_ready(cur);
    PG8_STAGE(PG8_SB(0, 0), cB, vbB, kc); PG8_STAGE(PG8_SB(0, 1), cB + hc, vbB, kc); PG8_STAGE(PG8_SA(0, 0), cA, vbA, kc); PG8_STAGE(PG8_SA(0, 1), cA + hc, vbA, kc);
    if (wr == 1) PG8_BAR;
    PG8_WAIT_V(2); PG8_BAR;
    PG8_STAGE(PG8_SB(1, 0), cB + kstep, vbB, kc); PG8_STAGE(PG8_SA(1, 0), cA + kstep, vbA, kc); PG8_STAGE(PG8_SB(1, 1), cB + hc + kstep, vbB, kc);
    PG8_WAIT_V(6); PG8_BAR;
    for (;;) {
        const bool has_next = S.next(ui + 1, nxt);
        const char* nA = cA; const char* nB = cB; hn = hc; kn = kc;
        if (has_next) { nA = (const char*)nxt.A; nB = (const char*)nxt.B; kn = nxt.K * 2; hn = (size_t)HALF * kn; }
        const int nt = cur.K / BK;
        for (int t = 0; t < nt; t += 2) {
            const bool last = (t == nt - 2);
            const char* a1 = cA + (size_t)(t + 1) * kstep;
            const char* a2 = last ? nA : cA + (size_t)(t + 2) * kstep; const char* b2 = last ? nB : cB + (size_t)(t + 2) * kstep;
            const char* a3 = a2 + kstep; const char* b3 = b2 + kstep;
            const int k2 = last ? kn : kc; const size_t h2 = last ? hn : hc;
            if (last && has_next) S.a_ready(nxt);
            PG8_LDB(B0, 0, 0); PG8_LDB(B1, 0, 1); PG8_SCHED; PG8_LDA(At, 0, 0); PG8_STAGE(PG8_SA(1, 1), a1 + hc, vbA, kc);
            PG8_WAIT_V(8); PG8_WAIT_L(0); PG8_BAR; PG8_MMA(0, 0, At, B0); PG8_MMA(0, 1, At, B1); PG8_BAR; PG8_SCHED;
            PG8_LDA(At, 0, 1); PG8_STAGE(PG8_SB(0, 0), b2, vbB, k2); PG8_STAGE(PG8_SB(0, 1), b2 + h2, vbB, k2); PG8_STAGE(PG8_SA(0, 0), a2, vbA, k2);
            PG8_WAIT_V(8); PG8_WAIT_L(0); PG8_BAR; PG8_MMA(1, 0, At, B0); PG8_MMA(1, 1, At, B1); PG8_BAR; PG8_SCHED;
            PG8_LDB(B0, 1, 0); PG8_LDB(B1, 1, 1); PG8_SCHED; PG8_LDA(At, 1, 0); PG8_STAGE(PG8_SA(0, 1), a2 + h2, vbA, k2);
            PG8_WAIT_V(8); PG8_WAIT_L(0); PG8_BAR; PG8_MMA(0, 0, At, B0); PG8_MMA(0, 1, At, B1); PG8_BAR; PG8_SCHED;
            PG8_LDA(At, 1, 1); PG8_STAGE(PG8_SB(1, 0), b3, vbB, k2); PG8_STAGE(PG8_SB(1, 1), b3 + h2, vbB, k2); PG8_STAGE(PG8_SA(1, 0), a3, vbA, k2);
            PG8_WAIT_V(8); PG8_WAIT_L(0); PG8_BAR; PG8_MMA(1, 0, At, B0); PG8_MMA(1, 1, At, B1); PG8_BAR; PG8_SCHED;
        }
        if (wr == 0) PG8_BAR;
        E(acc, cur, wr, wc, fr, fq);
        if (!has_next) break;
#pragma unroll
        for (int a = 0; a < 2; ++a)
#pragma unroll
            for (int b = 0; b < 2; ++b)
#pragma unroll
                for (int m = 0; m < 4; ++m)
#pragma unroll
                    for (int n = 0; n < 2; ++n) acc[a][b][m][n] = (f32x4){0.f, 0.f, 0.f, 0.f};
        cur = nxt; cA = nA; cB = nB; hc = hn; kc = kn;
        ++ui;
        if (wr == 1) PG8_BAR;
    }
    PG8_WAIT_V(0);
    PG8_BAR;
#undef PG8_SA
#undef PG8_SB
#undef PG8_STAGE
#undef PG8_VOFF
#undef PG8_LDA
#undef PG8_LDB
#undef PG8_MMA
#undef PG8_WAIT_V
#undef PG8_WAIT_L
#undef PG8_BAR
#undef PG8_SCHED
}
}
using pg8::GUnit;

struct Args { const float* in[20]; float* out; unsigned char* ws; };
struct Frame {
    LAS unsigned char* lds;
    int tid, lane, wave, G, bx;
    const float *x, *p, *w_in, *w_ap, *w_sp, *w_out, *a_re, *a_im, *log_dt, *b_re, *b_im, *c_re, *c_im, *dskip, *w_glu, *w_pg, *w_pp, *ln_g, *ln_b, *rel_bias;
    float* out;
    unsigned char* ws;
};
#define W_F32(off) ((float*)(F.ws + (off)))
#define W_BF(off) ((bf16_t*)(F.ws + (off)))
#define c_abar W_F32(WS_CONST + C_ABAR)
#define c_a256 W_F32(WS_CONST + C_A256)
#define c_bbar W_F32(WS_CONST + C_BBAR)
#define c_cfrag W_BF(WS_CONST + C_CFRAG)
#define c_lut W_F32(WS_CONST + C_LUT)
#define c_knh ((unsigned*)(F.ws + WS_CONST + C_KNH))
#define c_kmean W_F32(WS_CONST + C_KMEAN)
#define WtIn W_BF(WS_WIN)
#define WtAp W_BF(WS_WAP)
#define WtSp W_BF(WS_WSP)
#define WtOut W_BF(WS_WOUT)
#define WtGlu W_BF(WS_WGLU)
#define WtPg W_BF(WS_WPG)
#define WtPp W_BF(WS_WPP)
#define hloc W_F32(WS_HLOC)
#define XB W_BF(WS_XB)
#define PB W_BF(WS_PB)
#define QB W_BF(WS_QB)
#define KB W_BF(WS_QB + WS_BUFSTRIDE)
#define ZAB W_BF(WS_QB + 2 * WS_BUFSTRIDE)
#define UB W_BF(WS_QB + 3 * WS_BUFSTRIDE)
#define ZSB W_BF(WS_QB + 4 * WS_BUFSTRIDE)
#define VT W_BF(WS_VT)
#define GY W_BF(WS_GY)
#define OZS W_BF(WS_OZS)
#define MERGE W_BF(WS_MERGE)

enum { KA_STORE = 0, KA_VT = 1, KC_GLU = 2, KC_SIG0 = 3, KC_SIG1 = 4, KC_YA = 5, KC_YS = 6, KC_PLE = 7, KC_MIX = 8 };

struct Epi {
    Frame F;
    __device__ __forceinline__ void operator()(f32x4 (&acc)[2][2][4][2], const GUnit& u, int wr, int wc, int fr, int fq) const {
        int tid = threadIdx.x;
        const int kind = u.kind;
        float* scr = W_F32(WS_SCR) + (size_t)F.bx * (2 * 32 * NTHR * 4);
        const float* x = F.x; float* out = F.out;
        int lrow = wr * 64 + fr, lcol = wc * 32 + fq * 8;
        asm volatile("" : "+v"(lrow), "+v"(lcol), "+v"(tid));
        if (kind == KA_STORE) {
            const int pn = u.pn; const int buf = pn >> 1;
            bf16_t* base = QB + (size_t)buf * (WS_BUFSTRIDE / 2) + (size_t)(u.pm * 256) * AW + (pn & 1) * 256;
            const float sc = (buf == 0) ? QSCALE : 1.0f;
#pragma unroll
            for (int ai = 0; ai < 2; ++ai)
#pragma unroll
                for (int m = 0; m < 4; ++m) { bf16_t* rowp = base + (size_t)(unsigned)((ai * 128 + m * 16 + lrow) * AW + lcol);
#pragma unroll
                    for (int bj = 0; bj < 2; ++bj) { const f32x4 v0 = acc[ai][bj][m][0] * sc, v1 = acc[ai][bj][m][1] * sc;
                        u32x4 w; w.x = cvtpk(v0[0], v0[1]); w.y = cvtpk(v0[2], v0[3]); w.z = cvtpk(v1[0], v1[1]); w.w = cvtpk(v1[2], v1[3]);
                        *(u32x4*)(rowp + bj * 128) = w; } }
            if (buf == 1) {
#pragma unroll
                for (int bj = 0; bj < 2; ++bj) {
                    float cs[8]; float mx = 0.f;
#pragma unroll
                    for (int e = 0; e < 8; ++e) cs[e] = 0.f;
#pragma unroll
                    for (int ai = 0; ai < 2; ++ai)
#pragma unroll
                        for (int m = 0; m < 4; ++m) { const f32x4 v0 = acc[ai][bj][m][0], v1 = acc[ai][bj][m][1];
                            cs[0] += v0[0]; cs[1] += v0[1]; cs[2] += v0[2]; cs[3] += v0[3]; cs[4] += v1[0]; cs[5] += v1[1]; cs[6] += v1[2]; cs[7] += v1[3];
                            float q = (v0[0] * v0[0] + v0[1] * v0[1]) + (v0[2] * v0[2] + v0[3] * v0[3]) + (v1[0] * v1[0] + v1[1] * v1[1]) + (v1[2] * v1[2] + v1[3] * v1[3]);
                            q += __shfl_xor(q, 16); q += __shfl_xor(q, 32);
                            mx = fmaxf(mx, q); }
#pragma unroll
                    for (int o = 1; o < 16; o <<= 1) { mx = fmaxf(mx, __shfl_xor(mx, o));
#pragma unroll
                        for (int e = 0; e < 8; ++e) cs[e] += __shfl_xor(cs[e], o); }
                    const int col = (pn & 1) * 256 + bj * 128 + lcol;
                    if (fr == 0) {
#pragma unroll
                        for (int e = 0; e < 8; ++e) atomicAdd(c_kmean + (size_t)u.pm * AW + col + e, cs[e]);
                    }
                    if ((tid & 63) == 0) { const int head = col >> 6; atomicMax(c_knh + ((u.pm >> 5) * NH + head) * 2 + (wc & 1), __float_as_uint(mx)); }
                }
            }
        } else if (kind == KA_VT) {
            bf16_t* base = VT + (size_t)(u.pm * 256) * T + (size_t)u.pn * 256;
#pragma unroll
            for (int ai = 0; ai < 2; ++ai)
#pragma unroll
                for (int m = 0; m < 4; ++m) { bf16_t* rowp = base + (size_t)(unsigned)((ai * 128 + m * 16 + lrow) * T + lcol);
#pragma unroll
                    for (int bj = 0; bj < 2; ++bj) { const f32x4 v0 = acc[ai][bj][m][0], v1 = acc[ai][bj][m][1];
                        u32x4 w; w.x = cvtpk(v0[0], v0[1]); w.y = cvtpk(v0[2], v0[3]); w.z = cvtpk(v1[0], v1[1]); w.w = cvtpk(v1[2], v1[3]);
                        *(u32x4*)(rowp + bj * 128) = w; } }
        } else if (kind == KC_GLU) {
            const size_t row0 = (size_t)u.pm * 256; const int colb = u.pn * 128 + lcol;
#pragma unroll
            for (int ai = 0; ai < 2; ++ai)
#pragma unroll
                for (int m = 0; m < 4; ++m) { const size_t off = row0 * AW + (size_t)(unsigned)((ai * 128 + m * 16 + lrow) * AW + colb);
                    const u32x4 z = *(const u32x4*)(ZSB + off);
                    const f32x4 a0 = acc[ai][0][m][0], a1 = acc[ai][0][m][1], b0 = sig4(acc[ai][1][m][0]), b1 = sig4(acc[ai][1][m][1]);
                    float o[8];
                    o[0] = a0[0] * b0[0] * siluf_(bflo(z.x)); o[1] = a0[1] * b0[1] * siluf_(bfhi(z.x)); o[2] = a0[2] * b0[2] * siluf_(bflo(z.y)); o[3] = a0[3] * b0[3] * siluf_(bfhi(z.y));
                    o[4] = a1[0] * b1[0] * siluf_(bflo(z.z)); o[5] = a1[1] * b1[1] * siluf_(bfhi(z.z)); o[6] = a1[2] * b1[2] * siluf_(bflo(z.w)); o[7] = a1[3] * b1[3] * siluf_(bfhi(z.w));
                    u32x4 w; w.x = cvtpk(o[0], o[1]); w.y = cvtpk(o[2], o[3]); w.z = cvtpk(o[4], o[5]); w.w = cvtpk(o[6], o[7]);
                    *(u32x4*)(OZS + off) = w; asm volatile("" ::: "memory"); }
        } else if (kind == KC_SIG0 || kind == KC_SIG1 || kind == KC_YA) {
            f32x4* s = (f32x4*)scr + (size_t)(kind == KC_SIG1 ? 1 : 0) * (32 * NTHR) + tid;
#pragma unroll
            for (int ai = 0; ai < 2; ++ai)
#pragma unroll
                for (int bj = 0; bj < 2; ++bj)
#pragma unroll
                    for (int m = 0; m < 4; ++m)
#pragma unroll
                        for (int n = 0; n < 2; ++n) { const int idx = ((ai * 2 + bj) * 4 + m) * 2 + n;
                            if (kind == KC_YA) s[(size_t)idx * NTHR] = s[(size_t)idx * NTHR] * acc[ai][bj][m][n];
                            else s[(size_t)idx * NTHR] = sig4(acc[ai][bj][m][n]); if (n == 1 && (m & 1)) asm volatile("" ::: "memory"); }
        } else if (kind == KC_YS) {
            const f32x4* s0 = (const f32x4*)scr + tid; const f32x4* s1 = s0 + 32 * NTHR;
            bf16_t* base = MERGE + (size_t)(u.pm * 256) * DM + u.pn * 256;
#pragma unroll
            for (int ai = 0; ai < 2; ++ai)
#pragma unroll
                for (int m = 0; m < 4; ++m) { bf16_t* rowp = base + (size_t)(unsigned)((ai * 128 + m * 16 + lrow) * DM + lcol);
#pragma unroll
                    for (int bj = 0; bj < 2; ++bj) { const int idx = ((ai * 2 + bj) * 4 + m) * 2;
                        const f32x4 v0 = s0[(size_t)idx * NTHR] + s1[(size_t)idx * NTHR] * acc[ai][bj][m][0];
                        const f32x4 v1 = s0[(size_t)(idx + 1) * NTHR] + s1[(size_t)(idx + 1) * NTHR] * acc[ai][bj][m][1];
                        u32x4 w; w.x = cvtpk(v0[0], v0[1]); w.y = cvtpk(v0[2], v0[3]); w.z = cvtpk(v1[0], v1[1]); w.w = cvtpk(v1[2], v1[3]);
                        *(u32x4*)(rowp + bj * 128) = w; } asm volatile("" ::: "memory"); }
        } else {
            const f32x4* s0 = (const f32x4*)scr + tid;
            const size_t base = (size_t)(u.pm * 256) * DM + u.pn * 256;
#pragma unroll
            for (int ai = 0; ai < 2; ++ai)
#pragma unroll
                for (int m = 0; m < 4; ++m) { const size_t ro = base + (size_t)(unsigned)((ai * 128 + m * 16 + lrow) * DM + lcol);
#pragma unroll
                    for (int bj = 0; bj < 2; ++bj)
#pragma unroll
                        for (int n = 0; n < 2; ++n) { const int idx = ((ai * 2 + bj) * 4 + m) * 2 + n; const size_t o = ro + bj * 128 + n * 4;
                            f32x4 r;
                            if (kind == KC_PLE) r = *(const f32x4*)(x + o) * ALPHA + s0[(size_t)idx * NTHR] * acc[ai][bj][m][n];
                            else r = *(const f32x4*)(out + o) + acc[ai][bj][m][n];
                            *(f32x4*)(out + o) = r; } asm volatile("" ::: "memory"); }
        }
    }
};

struct SchedBase {
    __device__ __forceinline__ void a_ready(const GUnit& u) const {
        if (u.dep) { asm volatile("s_waitcnt vmcnt(0)" ::: "memory"); __builtin_amdgcn_s_barrier(); asm volatile("" ::: "memory"); }
    }
};
struct SchedA : SchedBase {
    Frame F; int panel;
    __device__ __forceinline__ bool next(int i, GUnit& u) const {
        if (i >= 12) return false;
        u.K = DM; u.dep = 0; u.pad = 0;
        if (i < 10) { u.A = XB + (size_t)panel * 256 * DM; u.B = WtIn + (size_t)i * 256 * DM; u.kind = KA_STORE; u.pm = panel; u.pn = i; }
        else { u.A = WtIn + (size_t)(2560 + 256 * (i - 10)) * DM; u.B = XB + (size_t)panel * 256 * DM; u.kind = KA_VT; u.pm = i - 10; u.pn = panel; }
        return true;
    }
};
struct SchedC : SchedBase {
    Frame F; int panel;
    __device__ __forceinline__ bool next(int i, GUnit& u) const {
        if (i >= 32) return false;
        u.pm = panel; u.dep = 0; u.pad = 0;
        const size_t pr = (size_t)panel * 256;
        if (i < 4) { u.A = GY + pr * AW; u.B = WtGlu + (size_t)i * 256 * AW; u.K = AW; u.kind = KC_GLU; u.pn = i; }
        else if (i < 20) { const int c = i - 4, pn = c >> 2, sub = c & 3; u.pn = pn;
            if (sub == 0) { u.A = XB + pr * DM; u.B = WtIn + (size_t)(3072 + 256 * pn) * DM; u.K = DM; u.kind = KC_SIG0; }
            else if (sub == 1) { u.A = ZAB + pr * AW; u.B = WtAp + (size_t)(256 * pn) * AW; u.K = AW; u.kind = KC_YA; }
            else if (sub == 2) { u.A = XB + pr * DM; u.B = WtIn + (size_t)(4096 + 256 * pn) * DM; u.K = DM; u.kind = KC_SIG1; }
            else { u.A = OZS + pr * AW; u.B = WtSp + (size_t)(256 * pn) * AW; u.K = AW; u.kind = KC_YS; u.dep = (pn == 0); } }
        else if (i < 28) { const int c = i - 20, pn = c >> 1, sub = c & 1; u.pn = pn;
            if (sub == 0) { u.A = XB + pr * DM; u.B = WtPg + (size_t)(256 * pn) * DM; u.K = DM; u.kind = KC_SIG0; }
            else { u.A = PB + pr * PLE; u.B = WtPp + (size_t)(256 * pn) * PLE; u.K = PLE; u.kind = KC_PLE; } }
        else { const int pn = i - 28; u.pn = pn; u.A = MERGE + pr * DM; u.B = WtOut + (size_t)(256 * pn) * DM; u.K = DM; u.kind = KC_MIX; u.dep = (pn == 0); }
        return true;
    }
};

__device__ __forceinline__ void transpose_item(const float* W, int K, int N, bf16_t* WT, int k0, int n0, int drow0, LAS float* scr, int lane) {
#pragma unroll 8
    for (int i = 0; i < 32; ++i) { const int kk = 2 * i + (lane >> 5); scr[kk * 33 + (lane & 31)] = W[(size_t)(k0 + kk) * N + n0 + (lane & 31)]; }
    asm volatile("s_waitcnt lgkmcnt(0)" ::: "memory");
    const int c = lane & 7;
#pragma unroll
    for (int j = 0; j < 4; ++j) { const int n = (lane >> 3) + 8 * j; const LAS float* s = scr + (8 * c) * 33 + n;
        u32x4 o; o.x = cvtpk(s[0 * 33], s[1 * 33]); o.y = cvtpk(s[2 * 33], s[3 * 33]); o.z = cvtpk(s[4 * 33], s[5 * 33]); o.w = cvtpk(s[6 * 33], s[7 * 33]);
        *(u32x4*)(WT + (size_t)(drow0 + n) * K + k0 + 8 * c) = o; }
    asm volatile("s_waitcnt lgkmcnt(0)" ::: "memory");
}
__device__ __forceinline__ int win_row(int n0) {
    const int blk = n0 >> 9, off = n0 & 511;
    const int d = (blk == 2) ? 5 : (blk >= 3 && blk <= 5) ? blk - 1 : blk;
    return d * 512 + off;
}
__device__ __forceinline__ int t5_bucket(int d) {
    if (d < 16) return d;
    int b = 16 + (int)(logf((float)d / 16.0f) / logf(8.0f) * 16.0f);
    return b > 31 ? 31 : b;
}
__device__ __forceinline__ void p0_prologue(Frame& F) {
    LAS float* scr = (LAS float*)(F.lds + F.wave * 16384);
    const int gw = F.bx * NWAVES + F.wave, NGW = F.G * NWAVES;
    constexpr int I_IN = 16 * 160, I_AP = 8 * 32, I_SP = 8 * 32, I_OUT = 16 * 32, I_GLU = 8 * 32, I_PG = 16 * 32, I_PP = 4 * 32;
    constexpr int NITEMS = I_IN + I_AP + I_SP + I_OUT + I_GLU + I_PG + I_PP;
    for (int it = gw; it < NITEMS; it += NGW) {
        int r = it;
        if (r < I_IN) { const int kb = r / 160, nb = r % 160; transpose_item(F.w_in, DM, 5120, WtIn, 64 * kb, 32 * nb, win_row(32 * nb), scr, F.lane); continue; } r -= I_IN;
        if (r < I_AP) { const int kb = r / 32, nb = r % 32; transpose_item(F.w_ap, AW, DM, WtAp, 64 * kb, 32 * nb, 32 * nb, scr, F.lane); continue; } r -= I_AP;
        if (r < I_SP) { const int kb = r / 32, nb = r % 32; transpose_item(F.w_sp, AW, DM, WtSp, 64 * kb, 32 * nb, 32 * nb, scr, F.lane); continue; } r -= I_SP;
        if (r < I_OUT) { const int kb = r / 32, nb = r % 32; transpose_item(F.w_out, DM, DM, WtOut, 64 * kb, 32 * nb, 32 * nb, scr, F.lane); continue; } r -= I_OUT;
        if (r < I_GLU) { const int kb = r / 32, nb = r % 32; const int n0 = 32 * nb, half = n0 >> 9, c = n0 & 511;
            transpose_item(F.w_glu, AW, DM, WtGlu, 64 * kb, n0, 256 * (c >> 7) + 128 * half + (c & 127), scr, F.lane); continue; } r -= I_GLU;
        if (r < I_PG) { const int kb = r / 32, nb = r % 32; transpose_item(F.w_pg, DM, DM, WtPg, 64 * kb, 32 * nb, 32 * nb, scr, F.lane); continue; } r -= I_PG;
        { const int kb = r / 32, nb = r % 32; transpose_item(F.w_pp, PLE, DM, WtPp, 64 * kb, 32 * nb, 32 * nb, scr, F.lane); }
    }
    const size_t gt = (size_t)F.bx * NTHR + F.tid, NGT = (size_t)F.G * NTHR;
    for (size_t i = gt; i < (size_t)T * DM / 8; i += NGT) { const f32x4 a = ((const f32x4*)F.x)[2 * i], b = ((const f32x4*)F.x)[2 * i + 1];
        u32x4 w; w.x = cvtpk(a[0], a[1]); w.y = cvtpk(a[2], a[3]); w.z = cvtpk(b[0], b[1]); w.w = cvtpk(b[2], b[3]); ((u32x4*)XB)[i] = w; }
    for (size_t i = gt; i < (size_t)T * PLE / 8; i += NGT) { const f32x4 a = ((const f32x4*)F.p)[2 * i], b = ((const f32x4*)F.p)[2 * i + 1];
        u32x4 w; w.x = cvtpk(a[0], a[1]); w.y = cvtpk(a[2], a[3]); w.z = cvtpk(b[0], b[1]); w.w = cvtpk(b[2], b[3]); ((u32x4*)PB)[i] = w; }
    for (size_t i = gt; i < (size_t)NPANEL * AW; i += NGT) c_kmean[i] = 0.f;
    if (gt < 128) c_knh[gt] = 0u;
    if (gt < SG * SP) {
        const int g = (int)gt / SP, pp = (int)gt % SP;
        const double dt = exp((double)F.log_dt[g]); const double ar = (double)F.a_re[gt], ai = (double)F.a_im[gt];
        const double mag = exp(dt * ar), ang = dt * ai; const double abr = mag * cos(ang), abi = mag * sin(ang);
        const double den = ar * ar + ai * ai, nr = abr - 1.0, ni = abi; const double fr = (nr * ar + ni * ai) / den, fi = (ni * ar - nr * ai) / den;
        c_abar[2 * gt] = (float)abr; c_abar[2 * gt + 1] = (float)abi;
        double pr = abr, pi = abi;
        for (int s = 0; s < 8; ++s) { const double nr2 = pr * pr - pi * pi, ni2 = 2.0 * pr * pi; pr = nr2; pi = ni2; }
        c_a256[2 * gt] = (float)pr; c_a256[2 * gt + 1] = (float)pi;
        for (int c = 0; c < SC; ++c) { const double br = (double)F.b_re[gt * SC + c], bi = (double)F.b_im[gt * SC + c];
            c_bbar[gt * 32 + c] = (float)(fr * br - fi * bi); c_bbar[gt * 32 + 16 + c] = (float)(fr * bi + fi * br); }
        (void)g; (void)pp;
    }
    if (gt >= 4096 && gt < 4096 + SG * 4 * 64) {
        const int id = (int)gt - 4096, g = id >> 8, s = (id >> 6) & 3, ln = id & 63, c = ln & 15;
        unsigned w[4];
#pragma unroll
        for (int j2 = 0; j2 < 4; ++j2) { float v[2];
#pragma unroll
            for (int e = 0; e < 2; ++e) { const int k = 32 * s + 8 * (ln >> 4) + 2 * j2 + e, pp = k >> 1; v[e] = (k & 1) ? -F.c_im[(g * SC + c) * SP + pp] : F.c_re[(g * SC + c) * SP + pp]; }
            w[j2] = cvtpk(v[0], v[1]); }
        *(u32x4*)(c_cfrag + (size_t)id * 8) = (u32x4){w[0], w[1], w[2], w[3]};
    }
    if (gt >= 16384 && gt < 16384 + NH) {
        const int h = (int)gt - 16384; float mx = -1e30f;
        for (int d = 0; d <= 128; ++d) { const float v = F.rel_bias[t5_bucket(d) * NH + h] * LOG2E; c_lut[h * 132 + d] = v; mx = fmaxf(mx, v); }
        c_lut[h * 132 + 129] = mx;
    }
}

__device__ __forceinline__ void ssm_load_u(const bf16_t* ub, size_t tok0, int g, int ntok, LAS float* us, int lane) {
    for (int it = 0; it < ntok / 32; ++it) { const int t = it * 32 + (lane >> 1), hf = lane & 1;
        const u32x4 w = *(const u32x4*)(ub + (tok0 + t) * AW + g * SC + hf * 8);
        LAS f32x4* d = (LAS f32x4*)(us + t * 16 + hf * 8);
        d[0] = (f32x4){bflo(w.x), bfhi(w.x), bflo(w.y), bfhi(w.y)}; d[1] = (f32x4){bflo(w.z), bfhi(w.z), bflo(w.w), bfhi(w.w)}; }
    asm volatile("s_waitcnt lgkmcnt(0)" ::: "memory");
}
__device__ __forceinline__ void ssm_step(float& hr, float& hi_, const float ar, const float ai, const float (&bre)[16], const float (&bim)[16], const LAS float* u) {
    const f32x4 u0 = ((const LAS f32x4*)u)[0], u1 = ((const LAS f32x4*)u)[1], u2 = ((const LAS f32x4*)u)[2], u3 = ((const LAS f32x4*)u)[3];
    float br = 0.f, bi = 0.f;
#pragma unroll
    for (int c = 0; c < 4; ++c) { br += bre[c] * u0[c]; bi += bim[c] * u0[c]; }
#pragma unroll
    for (int c = 0; c < 4; ++c) { br += bre[4 + c] * u1[c]; bi += bim[4 + c] * u1[c]; }
#pragma unroll
    for (int c = 0; c < 4; ++c) { br += bre[8 + c] * u2[c]; bi += bim[8 + c] * u2[c]; }
#pragma unroll
    for (int c = 0; c < 4; ++c) { br += bre[12 + c] * u3[c]; bi += bim[12 + c] * u3[c]; }
    const float nr = ar * hr - ai * hi_ + br, ni = ar * hi_ + ai * hr + bi;
    hr = nr; hi_ = ni;
}
__device__ __forceinline__ void ssm_pass1(Frame& F, int panel) {
    LAS float* us = (LAS float*)(F.lds + F.wave * 16384);
    const size_t tok0 = (size_t)panel * 256;
    for (int g = F.wave; g < SG; g += NWAVES) {
        ssm_load_u(UB, tok0, g, 256, us, F.lane);
        const int gp = g * SP + F.lane;
        const float ar = c_abar[2 * gp], ai = c_abar[2 * gp + 1];
        float bre[16], bim[16];
#pragma unroll
        for (int c = 0; c < 16; ++c) { bre[c] = c_bbar[gp * 32 + c]; bim[c] = c_bbar[gp * 32 + 16 + c]; }
        float hr = 0.f, hi_ = 0.f;
#pragma unroll 4
        for (int t = 0; t < 256; ++t) ssm_step(hr, hi_, ar, ai, bre, bim, us + t * 16);
        *(f32x2*)(hloc + ((size_t)panel * SG * SP + gp) * 2) = (f32x2){hr, hi_};
        asm volatile("s_waitcnt lgkmcnt(0)" ::: "memory");
    }
}
__device__ __forceinline__ void ssm_pass3(Frame& F, int panel) {
    LAS float* us = (LAS float*)(F.lds + F.wave * 16384);
    LAS unsigned char* ht = F.lds + F.wave * 16384 + 8192;
    const size_t tok0 = (size_t)panel * 256; const int cidx = panel & 31, lane = F.lane;
    for (int g = F.wave; g < SG; g += NWAVES) {
        const int gp = g * SP + lane;
        const float ar = c_abar[2 * gp], ai = c_abar[2 * gp + 1], a2r = c_a256[2 * gp], a2i = c_a256[2 * gp + 1];
        float bre[16], bim[16];
#pragma unroll
        for (int c = 0; c < 16; ++c) { bre[c] = c_bbar[gp * 32 + c]; bim[c] = c_bbar[gp * 32 + 16 + c]; }
        bf16x8 cf[4];
#pragma unroll
        for (int s = 0; s < 4; ++s) cf[s] = *(const bf16x8*)(c_cfrag + ((size_t)(g * 4 + s) * 64 + lane) * 8);
        const float dsk = F.dskip[g * SC + (lane & 15)];
        float hr = 0.f, hi_ = 0.f;
        for (int c2 = 0; c2 < cidx; ++c2) { const f32x2 hl = *(const f32x2*)(hloc + ((size_t)(panel - cidx + c2) * SG * SP + gp) * 2);
            const float nr = a2r * hr - a2i * hi_ + hl.x, ni = a2r * hi_ + a2i * hr + hl.y; hr = nr; hi_ = ni; }
        for (int half = 0; half < 2; ++half) {
            ssm_load_u(UB, tok0 + half * 128, g, 128, us, lane);
            for (int t16 = 0; t16 < 8; ++t16) {
#pragma unroll 4
                for (int tt = 0; tt < 16; ++tt) { ssm_step(hr, hi_, ar, ai, bre, bim, us + (t16 * 16 + tt) * 16);
                    *(LAS unsigned*)(ht + tt * 272 + lane * 4) = cvtpk(hr, hi_); }
                asm volatile("s_waitcnt lgkmcnt(0)" ::: "memory");
                f32x4 y = (f32x4){0.f, 0.f, 0.f, 0.f};
#pragma unroll
                for (int s = 0; s < 4; ++s) { const bf16x8 a = *(const LAS bf16x8*)(ht + (lane & 15) * 272 + (32 * s + 8 * (lane >> 4)) * 2);
                    y = __builtin_amdgcn_mfma_f32_16x16x32_bf16(a, cf[s], y, 0, 0, 0); }
#pragma unroll
                for (int r = 0; r < 4; ++r) { const int tl = t16 * 16 + 4 * (lane >> 4) + r;
                    const float v = y[r] + dsk * us[tl * 16 + (lane & 15)];
                    const unsigned w = cvtpk(gelu_f(v), 0.f);
                    GY[(tok0 + half * 128 + tl) * AW + g * SC + (lane & 15)] = (bf16_t)(w & 0xffffu); }
                asm volatile("s_waitcnt lgkmcnt(0)" ::: "memory");
            }
        }
    }
}

constexpr int AT_K0 = 0, AT_V0 = 65536, AT_VSZ = 64 * 520, AT_LUT = AT_V0 + 2 * AT_VSZ, AT_LSC = AT_LUT + 544;
__device__ __forceinline__ void at_load(const Frame& F, int b, int h, int j, u32x4 (&kr)[4], u32x4 (&vr)[4]) {
    const int tid = F.tid;
    const bf16_t* ks = KB + ((size_t)(b * SEQ + j * 256 + (tid >> 1))) * AW + h * HD + (tid & 1) * 32;
    const bf16_t* vs = VT + ((size_t)(h * HD + (tid >> 3))) * T + (size_t)b * SEQ + j * 256 + (tid & 7) * 32;
#pragma unroll
    for (int i = 0; i < 4; ++i) { kr[i] = *(const u32x4*)(ks + 8 * i); vr[i] = *(const u32x4*)(vs + 8 * i); }
}
__device__ __forceinline__ void at_store(const Frame& F, int buf, const u32x4 (&kr)[4], const u32x4 (&vr)[4]) {
    const int tid = F.tid; const int key = tid >> 1, c0 = (tid & 1) * 4, d = tid >> 3, v0 = (tid & 7) * 4;
    LAS unsigned char* kb = F.lds + AT_K0 + buf * 32768 + key * 128; LAS unsigned char* vb = F.lds + AT_V0 + buf * AT_VSZ + d * 520;
#pragma unroll
    for (int i = 0; i < 4; ++i) { *(LAS u32x4*)(kb + (((c0 + i) ^ ((key >> 1) & 7)) << 4)) = kr[i];
        *(LAS u32x2*)(vb + (v0 + i) * 16) = (u32x2){vr[i].x, vr[i].y}; *(LAS u32x2*)(vb + (v0 + i) * 16 + 8) = (u32x2){vr[i].z, vr[i].w}; }
}
#define TOP3_INS(val, j) do { if ((val) > v0) { v2 = v1; i2 = i1; v1 = v0; i1 = i0; v0 = (val); i0 = (j); } else if ((val) > v1) { v2 = v1; i2 = i1; v1 = (val); i1 = (j); } else if ((val) > v2) { v2 = (val); i2 = (j); } } while (0)
#define TOP3_INS_T(val, j) do { const float _v = (val); const int _j = (j); if (_j >= 0) { \
        if (_v > v0 || (_v == v0 && _j < i0)) { v2 = v1; i2 = i1; v1 = v0; i1 = i0; v0 = _v; i0 = _j; } \
        else if (_v > v1 || (_v == v1 && _j < i1)) { v2 = v1; i2 = i1; v1 = _v; i1 = _j; } \
        else if (_v > v2 || (_v == v2 && _j < i2)) { v2 = _v; i2 = _j; } } } while (0)
__device__ __forceinline__ void attn_unit(Frame& F, int b, int h, int blk) {
    const int lane = F.lane, w = F.wave, ql = lane & 31, hi = lane >> 5, tid = F.tid;
    const float NEG = -__builtin_inff();
    LAS float* lutL = (LAS float*)(F.lds + AT_LUT);
    LAS float* lsc = (LAS float*)(F.lds + AT_LSC) + w * 32;
    const size_t tok0 = (size_t)b * SEQ + blk * 256;
    u32x4 kr[4], vr[4];
    at_load(F, b, h, 0, kr, vr);
    if (tid < 132) lutL[tid] = c_lut[h * 132 + tid];
    bf16x8 qf[4];
    { const bf16_t* qp = QB + (tok0 + 32 * w + ql) * AW + h * HD + 8 * hi;
#pragma unroll
        for (int d0 = 0; d0 < 4; ++d0) qf[d0] = *(const bf16x8*)(qp + 16 * d0); }
    float qn = 0.f;
#pragma unroll
    for (int d0 = 0; d0 < 4; ++d0)
#pragma unroll
        for (int e = 0; e < 8; ++e) { const float f = bf2f((unsigned short)qf[d0][e]); qn += f * f; }
    qn += __shfl_xor(qn, 32);
    unsigned selmask = 0u;
    if (blk > 0) {
        f32x16 g;
#pragma unroll
        for (int r = 0; r < 16; ++r) g[r] = 0.f;
        const float* km = c_kmean + (size_t)(b * 32 + ql) * AW + h * HD + 8 * hi;
#pragma unroll
        for (int d0 = 0; d0 < 4; ++d0) { const f32x4 a = *(const f32x4*)(km + 16 * d0), c = *(const f32x4*)(km + 16 * d0 + 4);
            u32x4 wv; wv.x = cvtpk(a[0], a[1]); wv.y = cvtpk(a[2], a[3]); wv.z = cvtpk(c[0], c[1]); wv.w = cvtpk(c[2], c[3]);
            g = __builtin_amdgcn_mfma_f32_32x32x16_bf16(__builtin_bit_cast(bf16x8, wv), qf[d0], g, 0, 0, 0); }
        float v0 = NEG, v1 = NEG, v2 = NEG; int i0 = -1, i1 = -1, i2 = -1;
#pragma unroll
        for (int r = 0; r < 16; ++r) { const int j = crow(r, hi); const float val = (j < blk) ? g[r] : NEG; TOP3_INS(val, j); }
        const float p0 = __shfl_xor(v0, 32), p1 = __shfl_xor(v1, 32), p2 = __shfl_xor(v2, 32);
        const int j0 = __shfl_xor(i0, 32), j1 = __shfl_xor(i1, 32), j2 = __shfl_xor(i2, 32);
        TOP3_INS_T(p0, j0); TOP3_INS_T(p1, j1); TOP3_INS_T(p2, j2);
        if (i0 >= 0) selmask |= 1u << i0;
        if (i1 >= 0) selmask |= 1u << i1;
        if (i2 >= 0) selmask |= 1u << i2;
    }
    at_store(F, 0, kr, vr);
    asm volatile("s_waitcnt lgkmcnt(0)" ::: "memory"); __builtin_amdgcn_s_barrier(); asm volatile("" ::: "memory");
    const unsigned* kn = c_knh + (b * NH + h) * 2;
    const float kn2 = __uint_as_float(kn[0]) + __uint_as_float(kn[1]);
    const float negM = -(sqrtf(qn * kn2) * 1.01f + lutL[129]);
    const float c31 = lutL[128];
    f32x16 o[2];
#pragma unroll
    for (int r = 0; r < 16; ++r) { o[0][r] = 0.f; o[1][r] = 0.f; }
    float lsum = 0.f;
    for (int j = 0; j <= blk; ++j) {
        const int buf = j & 1;
        if (j < blk) at_load(F, b, h, j + 1, kr, vr);
        const bool own = (j == blk), prev = (j == blk - 1);
        const bool sel = own || ((selmask >> j) & 1u);
        if (__any(sel)) {
            const float addc = sel ? (negM + c31) : NEG;
            const int ktmax = own ? w : 7;
            const LAS unsigned char* kbase = F.lds + AT_K0 + buf * 32768;
            const LAS unsigned char* vbase = F.lds + AT_V0 + buf * AT_VSZ;
            for (int kt = 0; kt <= ktmax; ++kt) {
                f32x16 s;
#pragma unroll
                for (int r = 0; r < 16; ++r) s[r] = 0.f;
                const int key = 32 * kt + ql;
#pragma unroll
                for (int d0 = 0; d0 < 4; ++d0) { const bf16x8 kf = *(const LAS bf16x8*)(kbase + key * 128 + (((2 * d0 + hi) ^ ((key >> 1) & 7)) << 4));
                    s = __builtin_amdgcn_mfma_f32_32x32x16_bf16(kf, qf[d0], s, 0, 0, 0); }
                const bool near = own ? (w - kt <= 4) : (prev && (kt - w >= 4));
                float pr[16];
                if (near) {
                    const int dbase = (own ? 0 : 256) + 32 * w + ql - 32 * kt;
#pragma unroll
                    for (int r = 0; r < 16; ++r) { const int dist = dbase - crow(r, hi);
                        float add = (dist < 0 || !sel) ? NEG : negM + lutL[dist > 128 ? 128 : (dist < 0 ? 0 : dist)];
                        pr[r] = __builtin_amdgcn_exp2f(s[r] + add); }
                } else {
#pragma unroll
                    for (int r = 0; r < 16; ++r) pr[r] = __builtin_amdgcn_exp2f(s[r] + addc);
                }
                float ls = 0.f;
#pragma unroll
                for (int r = 0; r < 16; ++r) ls += pr[r];
                lsum += ls;
                u32x4 pw0, pw1;
                pw0.x = cvtpk(pr[0], pr[1]); pw0.y = cvtpk(pr[2], pr[3]); pw0.z = cvtpk(pr[4], pr[5]); pw0.w = cvtpk(pr[6], pr[7]);
                pw1.x = cvtpk(pr[8], pr[9]); pw1.y = cvtpk(pr[10], pr[11]); pw1.z = cvtpk(pr[12], pr[13]); pw1.w = cvtpk(pr[14], pr[15]);
                const bf16x8 pa0 = __builtin_bit_cast(bf16x8, pw0), pa1 = __builtin_bit_cast(bf16x8, pw1);
#pragma unroll
                for (int dh = 0; dh < 2; ++dh) { const LAS unsigned char* vp = vbase + (32 * dh + ql) * 520 + (32 * kt + 4 * hi) * 2;
                    const u32x2 a0 = *(const LAS u32x2*)(vp), a1 = *(const LAS u32x2*)(vp + 16), b0 = *(const LAS u32x2*)(vp + 32), b1 = *(const LAS u32x2*)(vp + 48);
                    const u32x4 vf0 = (u32x4){a0.x, a0.y, a1.x, a1.y}, vf1 = (u32x4){b0.x, b0.y, b1.x, b1.y};
                    o[dh] = __builtin_amdgcn_mfma_f32_32x32x16_bf16(pa0, __builtin_bit_cast(bf16x8, vf0), o[dh], 0, 0, 0);
                    o[dh] = __builtin_amdgcn_mfma_f32_32x32x16_bf16(pa1, __builtin_bit_cast(bf16x8, vf1), o[dh], 0, 0, 0); }
            }
        }
        if (j < blk) at_store(F, buf ^ 1, kr, vr);
        asm volatile("s_waitcnt lgkmcnt(0)" ::: "memory"); __builtin_amdgcn_s_barrier(); asm volatile("" ::: "memory");
    }
    lsum += __shfl_xor(lsum, 32);
    if (hi == 0) lsc[ql] = lsum;
    asm volatile("s_waitcnt lgkmcnt(0)" ::: "memory");
#pragma unroll
    for (int r = 0; r < 16; ++r) { const int qr = crow(r, hi); const float rl = __builtin_amdgcn_rcpf(lsc[qr]);
#pragma unroll
        for (int dh = 0; dh < 2; ++dh) { bf16_t* zp = ZAB + (tok0 + 32 * w + qr) * AW + h * HD + 32 * dh + ql;
            const float z = bf2f(*zp); const unsigned wv = cvtpk(o[dh][r] * rl * siluf_(z), 0.f); *zp = (bf16_t)(wv & 0xffffu); } }
    asm volatile("s_waitcnt lgkmcnt(0)" ::: "memory"); __builtin_amdgcn_s_barrier(); asm volatile("" ::: "memory");
}

__device__ __forceinline__ void ln_panel(Frame& F, int panel) {
    const int lane = F.lane;
    f32x4 gv[4], bv[4];
#pragma unroll
    for (int j = 0; j < 4; ++j) { gv[j] = *(const f32x4*)(F.ln_g + 4 * lane + 256 * j); bv[j] = *(const f32x4*)(F.ln_b + 4 * lane + 256 * j); }
    for (int rr = 0; rr < 32; ++rr) {
        float* row = F.out + ((size_t)panel * 256 + F.wave * 32 + rr) * DM + 4 * lane;
        f32x4 v[4]; float s = 0.f;
#pragma unroll
        for (int j = 0; j < 4; ++j) { v[j] = *(const f32x4*)(row + 256 * j); s += (v[j][0] + v[j][1]) + (v[j][2] + v[j][3]); }
#pragma unroll
        for (int o = 1; o < 64; o <<= 1) s += __shfl_xor(s, o);
        const float mean = s * (1.0f / DM); float q = 0.f;
#pragma unroll
        for (int j = 0; j < 4; ++j) { v[j] = v[j] - mean; q += (v[j][0] * v[j][0] + v[j][1] * v[j][1]) + (v[j][2] * v[j][2] + v[j][3] * v[j][3]); }
#pragma unroll
        for (int o = 1; o < 64; o <<= 1) q += __shfl_xor(q, o);
        const float rstd = 1.0f / sqrtf(q * (1.0f / DM) + LN_EPS);
#pragma unroll
        for (int j = 0; j < 4; ++j) *(f32x4*)(row + 256 * j) = v[j] * rstd * gv[j] + bv[j];
    }
}

__global__ void __launch_bounds__(NTHR, 2) fwd_kernel(Args args) {
    extern __shared__ __attribute__((aligned(16))) unsigned char lds_raw[];
    cg::grid_group grid = cg::this_grid();
    Frame F;
    F.lds = (LAS unsigned char*)lds_raw;
    F.tid = threadIdx.x; F.lane = F.tid & 63; F.wave = __builtin_amdgcn_readfirstlane(F.tid >> 6); F.G = gridDim.x; F.bx = blockIdx.x;
    F.x = args.in[0]; F.p = args.in[1]; F.w_in = args.in[2]; F.w_ap = args.in[3]; F.w_sp = args.in[4]; F.w_out = args.in[5];
    F.a_re = args.in[6]; F.a_im = args.in[7]; F.log_dt = args.in[8]; F.b_re = args.in[9]; F.b_im = args.in[10]; F.c_re = args.in[11]; F.c_im = args.in[12];
    F.dskip = args.in[13]; F.w_glu = args.in[14]; F.w_pg = args.in[15]; F.w_pp = args.in[16]; F.ln_g = args.in[17]; F.ln_b = args.in[18]; F.rel_bias = args.in[19];
    F.out = args.out;
    F.ws = args.ws;
    Epi E; E.F = F;

#ifndef NO_P0
    p0_prologue(F);
#endif
    grid.sync();

#define REFRESH() asm volatile("" : "+v"(F.tid), "+v"(F.lane))
    REFRESH();
    for (int panel = F.bx; panel < NPANEL; panel += F.G) {
        REFRESH(); E.F = F;
        SchedA S; S.F = F; S.panel = panel;
#ifndef NO_P1G
        pg8::gemm_units<SchedA, Epi>(F.lds, S, E);
#endif
#ifndef NO_P1S
        ssm_pass1(F, panel);
#endif
        __syncthreads();
    }
    grid.sync();

    REFRESH();
    {
        const int nunits = BATCH * NH * 32;
        for (int round = 0;; ++round) {
            const int pos = (round & 1) ? (F.G - 1 - F.bx) : F.bx;
            const int idx = round * F.G + pos;
            if (round * F.G >= nunits) break;
#ifndef NO_P2A
            if (idx < nunits) { const int blk = 31 - idx / 64, bh = idx % 64; attn_unit(F, bh >> 3, bh & 7, blk); }
#endif
        }
#ifndef NO_P2S
        for (int panel = F.bx; panel < NPANEL; panel += F.G) { ssm_pass3(F, panel); }
#endif
    }
    grid.sync();

    REFRESH();
    for (int panel = F.bx; panel < NPANEL; panel += F.G) {
        REFRESH(); E.F = F;
        SchedC S; S.F = F; S.panel = panel;
#ifndef NO_P3G
        pg8::gemm_units<SchedC, Epi>(F.lds, S, E);
#endif
        asm volatile("s_waitcnt vmcnt(0)" ::: "memory"); __syncthreads();
#ifndef NO_P3L
        ln_panel(F, panel);
#endif
        __syncthreads();
    }
}

extern "C" void kernel_launch(void* const* d_in, const int* in_sizes, int n_in, void* d_out, int out_size, void* d_ws, size_t ws_size, hipStream_t stream) {
    static int grid = 0;
    if (grid == 0) {
        if (n_in != 20 || in_sizes[0] != T * DM || out_size != T * DM || ws_size < WS_END) {
            fprintf(stderr, "kernel_launch: unexpected problem (n_in %d, in0 %d, out %d, ws %zu < %zu); nothing launched\n", n_in, n_in > 0 ? in_sizes[0] : -1, out_size, ws_size, (size_t)WS_END); grid = -1; return; }
        int dev = 0, cus = 0, per_cu = 0;
        if (hipGetDevice(&dev) != hipSuccess || hipDeviceGetAttribute(&cus, hipDeviceAttributeMultiprocessorCount, dev) != hipSuccess) { grid = -1; return; }
        if (hipFuncSetAttribute((const void*)fwd_kernel, hipFuncAttributeMaxDynamicSharedMemorySize, LDS_BYTES) != hipSuccess) { fprintf(stderr, "kernel_launch: hipFuncSetAttribute failed\n"); grid = -1; return; }
        if (hipOccupancyMaxActiveBlocksPerMultiprocessor(&per_cu, (const void*)fwd_kernel, NTHR, LDS_BYTES) != hipSuccess || per_cu < 1) { fprintf(stderr, "kernel_launch: occupancy query says %d\n", per_cu); per_cu = 1; }
        (void)hipGetLastError();
        grid = cus;
        if (grid > 256) grid = 256;
    }
    if (grid < 0) return;
    Args a{};
    for (int i = 0; i < 20; ++i) a.in[i] = (const float*)d_in[i];
    a.out = (float*)d_out; a.ws = (unsigned char*)d_ws;
    void* kargs[] = {&a};
    hipError_t e = hipLaunchCooperativeKernel((const void*)fwd_kernel, dim3(grid), dim3(NTHR), kargs, LDS_BYTES, stream);
    if (e != hipSuccess) fprintf(stderr, "kernel_launch: cooperative launch failed: %s (grid %d)\n", hipGetErrorString(e), grid);
}
```
